# Optimizing an MI355X kernel written in HIP

```python
import jax, jax.numpy as jnp
from jax import lax
import numpy as np

D_MODEL = 1024
BATCH = 1
SEQ = 16384
DEPTH = 1

GRID_W = 64
CTX_LEN = 256
FOURIER_WIDTH = D_MODEL // 2
FOURIER_GROUPS = 4
FOURIER_GROUP_DIM = FOURIER_WIDTH // FOURIER_GROUPS
HGRN_WIDTH = D_MODEL // 2
HGRN_HEAD_DIM = 128
HGRN_HEADS = HGRN_WIDTH // HGRN_HEAD_DIM
CHUNK = 64
N_BRANCHES = 2
D_FF = 4 * D_MODEL
N_MOD = 6
POS_BASE = 10000.0
LN_EPS = 1e-5
RMS_EPS = 1e-6
DEEPNORM_ALPHA = (2.0 * DEPTH) ** 0.25
DEEPNORM_BETA = (8.0 * DEPTH) ** -0.25
PROJ_SPLITS = (FOURIER_WIDTH, FOURIER_WIDTH + HGRN_WIDTH, FOURIER_WIDTH + 2 * HGRN_WIDTH,
               FOURIER_WIDTH + 3 * HGRN_WIDTH, FOURIER_WIDTH + 4 * HGRN_WIDTH, FOURIER_WIDTH + 5 * HGRN_WIDTH)
PROJ_WIDTH = FOURIER_WIDTH + 5 * HGRN_WIDTH + N_BRANCHES * D_MODEL

kernel_name = 'hybrid_fnet_hgrn2_adaln_deepnorm_block'


def _layernorm(x, g, b):
    xf = x.astype(jnp.float32)
    mu = jnp.mean(xf, axis=-1, keepdims=True)
    var = jnp.mean(jnp.square(xf - mu), axis=-1, keepdims=True)
    return ((xf - mu) * lax.rsqrt(var + LN_EPS) * g + b).astype(x.dtype)


def _modulate(x, shift, scale):
    return x * (1 + scale) + shift


def _sincos_2d(rows, cols, dim):
    quarter = dim // 4
    omega = 1.0 / (POS_BASE ** (jnp.arange(quarter, dtype=jnp.float32) / quarter))
    r = jnp.arange(rows, dtype=jnp.float32)[:, None] * omega
    cc = jnp.arange(cols, dtype=jnp.float32)[:, None] * omega
    er = jnp.concatenate([jnp.sin(r), jnp.cos(r)], axis=-1)
    ec = jnp.concatenate([jnp.sin(cc), jnp.cos(cc)], axis=-1)
    emb = jnp.concatenate([jnp.broadcast_to(er[:, None, :], (rows, cols, dim // 2)),
                           jnp.broadcast_to(ec[None, :, :], (rows, cols, dim // 2))], axis=-1)
    return emb.reshape(rows * cols, dim)


def _lower_bounds(logits):
    p = jax.nn.softmax(logits.astype(jnp.float32), axis=1)
    return jnp.cumsum(p, axis=1)[:, :DEPTH]


def _split_heads(t):
    B, T, _ = t.shape
    return t.reshape(B, T, HGRN_HEADS, HGRN_HEAD_DIM).transpose(0, 2, 1, 3)


def _chunk_scan(q, k, v, log_f, s0):
    B, H, T, DK = q.shape
    DV = v.shape[-1]
    n = T // CHUNK

    def to_chunks(t):
        return jnp.moveaxis(t.astype(jnp.float32).reshape(B, H, n, CHUNK, t.shape[-1]), 2, 0)

    mask = jnp.tril(jnp.ones((CHUNK, CHUNK), dtype=bool))[:, :, None]

    def step(S, inp):
        qc, kc, vc, gc = inp
        b = jnp.cumsum(gc, axis=2)
        o_inter = jnp.einsum('bhtk,bhkv->bhtv', qc * jnp.exp(b), S)
        rel = b[:, :, :, None, :] - b[:, :, None, :, :]
        decay = jnp.where(mask, jnp.exp(jnp.minimum(rel, 0.0)), 0.0)
        scores = jnp.einsum('bhtk,bhsk,bhtsk->bhts', qc, kc, decay)
        o_intra = jnp.einsum('bhts,bhsv->bhtv', scores, vc)
        b_last = b[:, :, -1:, :]
        S_new = (jnp.exp(b_last[:, :, 0, :])[..., None] * S
                 + jnp.einsum('bhsk,bhsv->bhkv', kc * jnp.exp(b_last - b), vc))
        return S_new, o_inter + o_intra

    S_T, o = lax.scan(step, s0, (to_chunks(q), to_chunks(k), to_chunks(v), to_chunks(log_f)))
    o = jnp.moveaxis(o, 0, 2).reshape(B, H, T, DV)
    return o.astype(v.dtype), S_T


def _hgrn_direction(q, v, f_pre, lb, s0):
    lb = lb.reshape(HGRN_HEADS, 1, HGRN_HEAD_DIM)
    f = lb + (1.0 - lb) * jax.nn.sigmoid(f_pre.astype(jnp.float32))
    return _chunk_scan(q, 1.0 - f, v, jnp.log(f), s0)


def _hgrn_branch(q, v, f_fwd, f_bwd, og, norm_g, lb_fwd, lb_bwd, s0_fwd, s0_bwd):
    qh = _split_heads(jax.nn.silu(q))
    vh = _split_heads(v)
    o_f, s_f = _hgrn_direction(qh, vh, _split_heads(f_fwd), lb_fwd, s0_fwd)
    o_b, s_b = _hgrn_direction(qh[:, :, ::-1], vh[:, :, ::-1], _split_heads(f_bwd)[:, :, ::-1], lb_bwd, s0_bwd)
    o = (o_f + o_b[:, :, ::-1]).astype(jnp.float32)
    o = o * lax.rsqrt(jnp.mean(jnp.square(o), axis=-1, keepdims=True) + RMS_EPS)
    B, H, T, dh = o.shape
    o = (o.transpose(0, 2, 1, 3).reshape(B, T, H * dh) * norm_g).astype(q.dtype)
    return o * jax.nn.silu(og), s_f, s_b


def _fourier_mix(u):
    B, T, _ = u.shape
    ug = u.astype(jnp.float32).reshape(B, T, FOURIER_GROUPS, FOURIER_GROUP_DIM)
    y = jnp.fft.fft2(ug, axes=(1, 3), norm='ortho').real
    return y.reshape(B, T, FOURIER_WIDTH).astype(u.dtype)


def _merge(u_four, o_hgrn, gate_pre, w_fp, w_hp, w_o, b_o):
    g_four, g_hgrn = jnp.split(jax.nn.sigmoid(gate_pre.astype(jnp.float32)).astype(u_four.dtype), N_BRANCHES, axis=-1)
    y = g_four * (_fourier_mix(u_four) @ w_fp) + g_hgrn * (o_hgrn @ w_hp)
    return y @ w_o + b_o


def _mlp(h, w1, b1, w2, b2):
    return jnp.square(jax.nn.relu(h @ w1 + b1)) @ w2 + b2


def setup_inputs(seed: int = 0) -> dict:
    key = jax.random.key(seed)
    ks = jax.random.split(key, 24)
    f32 = jnp.float32
    D = D_MODEL
    nrm = lambda k, shape, s: jax.random.normal(k, shape, f32) * s
    w_in = nrm(ks[4], (DEPTH, D, PROJ_WIDTH), D ** -0.5)
    v_lo, v_hi = PROJ_SPLITS[1], PROJ_SPLITS[2]
    w_in = w_in.at[:, :, v_lo:v_hi].multiply(DEEPNORM_BETA)
    return {
        'x': nrm(ks[0], (BATCH, SEQ, D), 1.0),
        'c': nrm(ks[1], (BATCH, D), 1.0),
        'ctx': nrm(ks[2], (BATCH, CTX_LEN, D), 1.0),
        'c_ctx': nrm(ks[3], (D,), 1.0),
        'ln_in_g': 1.0 + nrm(ks[5], (D,), 0.02),
        'ln_in_b': nrm(ks[6], (D,), 0.02),
        'w_ada': nrm(ks[7], (DEPTH, D, N_MOD * D), D ** -0.5),
        'b_ada': nrm(ks[8], (DEPTH, N_MOD * D), 0.02),
        'w_in': w_in,
        'b_in': nrm(ks[9], (DEPTH, PROJ_WIDTH), 0.02),
        'hgrn_lb_logits': nrm(ks[10], (2, DEPTH + 1, HGRN_WIDTH), 0.5),
        'hgrn_norm_g': 1.0 + nrm(ks[11], (DEPTH, HGRN_WIDTH), 0.02),
        'w_four_proj': nrm(ks[12], (DEPTH, FOURIER_WIDTH, D), FOURIER_WIDTH ** -0.5 * DEEPNORM_BETA),
        'w_hgrn_proj': nrm(ks[13], (DEPTH, HGRN_WIDTH, D), HGRN_WIDTH ** -0.5 * DEEPNORM_BETA),
        'w_out': nrm(ks[14], (DEPTH, D, D), D ** -0.5 * DEEPNORM_BETA),
        'b_out': nrm(ks[15], (DEPTH, D), 0.02),
        'w_mlp1': nrm(ks[16], (DEPTH, D, D_FF), D ** -0.5 * DEEPNORM_BETA),
        'b_mlp1': nrm(ks[17], (DEPTH, D_FF), 0.02),
        'w_mlp2': nrm(ks[18], (DEPTH, D_FF, D), D_FF ** -0.5 * DEEPNORM_BETA),
        'b_mlp2': nrm(ks[19], (DEPTH, D), 0.02),
        'ln_post_g': 1.0 + nrm(ks[20], (DEPTH, 2, D), 0.02),
        'ln_post_b': nrm(ks[21], (DEPTH, 2, D), 0.02),
    }


def reference(x, c, ctx, c_ctx, ln_in_g, ln_in_b, w_ada, b_ada, w_in, b_in, hgrn_lb_logits, hgrn_norm_g,
              w_four_proj, w_hgrn_proj, w_out, b_out, w_mlp1, b_mlp1, w_mlp2, b_mlp2, ln_post_g, ln_post_b):
    B, T, D = x.shape
    rows = T // GRID_W
    pos = _sincos_2d(rows, GRID_W, D).astype(x.dtype)
    xl = _layernorm(x + pos[None], ln_in_g, ln_in_b)
    xc = _layernorm(ctx, ln_in_g, ln_in_b)
    lbs = _lower_bounds(hgrn_lb_logits)
    s_zero = jnp.zeros((B, HGRN_HEADS, HGRN_HEAD_DIM, HGRN_HEAD_DIM), jnp.float32)

    for l in range(DEPTH):
        mod_l = jnp.split((jax.nn.silu(c) @ w_ada[l] + b_ada[l])[:, None, :], N_MOD, axis=-1)
        mod_c = jnp.split(jax.nn.silu(c_ctx) @ w_ada[l] + b_ada[l], N_MOD, axis=-1)
        lb_f, lb_b = lbs[0, l], lbs[1, l]

        hc = _modulate(xc, mod_c[0], mod_c[1])
        pc = jnp.split(hc @ w_in[l] + b_in[l], PROJ_SPLITS, axis=-1)
        oc_h, s_f, s_b = _hgrn_branch(pc[1], pc[2], pc[3], pc[4], pc[5], hgrn_norm_g[l], lb_f, lb_b, s_zero, s_zero)
        if l < DEPTH - 1:
            mix_c = _merge(pc[0], oc_h, pc[6], w_four_proj[l], w_hgrn_proj[l], w_out[l], b_out[l])
            xc = _layernorm(DEEPNORM_ALPHA * xc + mod_c[2] * mix_c, ln_post_g[l, 0], ln_post_b[l, 0])
            hc2 = _modulate(xc, mod_c[3], mod_c[4])
            xc = _layernorm(DEEPNORM_ALPHA * xc + mod_c[5] * _mlp(hc2, w_mlp1[l], b_mlp1[l], w_mlp2[l], b_mlp2[l]),
                            ln_post_g[l, 1], ln_post_b[l, 1])

        hl = _modulate(xl, mod_l[0], mod_l[1])
        pl = jnp.split(hl @ w_in[l] + b_in[l], PROJ_SPLITS, axis=-1)
        ol_h, _, _ = _hgrn_branch(pl[1], pl[2], pl[3], pl[4], pl[5], hgrn_norm_g[l], lb_f, lb_b, s_f, s_b)
        mix_l = _merge(pl[0], ol_h, pl[6], w_four_proj[l], w_hgrn_proj[l], w_out[l], b_out[l])
        xl = _layernorm(DEEPNORM_ALPHA * xl + mod_l[2] * mix_l, ln_post_g[l, 0], ln_post_b[l, 0])
        hl2 = _modulate(xl, mod_l[3], mod_l[4])
        xl = _layernorm(DEEPNORM_ALPHA * xl + mod_l[5] * _mlp(hl2, w_mlp1[l], b_mlp1[l], w_mlp2[l], b_mlp2[l]),
                        ln_post_g[l, 1], ln_post_b[l, 1])
    return xl
```

```cpp
#include <hip/hip_runtime.h>
#include <hip/hip_cooperative_groups.h>
#include <cstdio>
namespace cg = cooperative_groups;

#define LAS __attribute__((address_space(3)))
typedef unsigned short u16;
typedef short bf16x8 __attribute__((ext_vector_type(8)));
typedef short s16x4 __attribute__((ext_vector_type(4)));
typedef float f32x4 __attribute__((ext_vector_type(4)));
typedef unsigned u32x4 __attribute__((ext_vector_type(4)));
typedef unsigned u32x2 __attribute__((ext_vector_type(2)));

constexpr int T_ = 16384, D_ = 1024, CTX_ = 256, MROWS = T_ + CTX_;
constexpr int NPROJ = 5632;
constexpr int DFF = 4096;
constexpr float ALPHA = 1.189207115002721f;
constexpr float LN_EPS = 1e-5f, RMS_EPS = 1e-6f;
constexpr float INV_SQRT128 = 0.08838834764831845f;

constexpr size_t MiB = 1u << 20;
constexpr size_t WS_WIN = 0, WS_WFP = 11 * MiB, WS_WHP = 12 * MiB, WS_WO = 13 * MiB, WS_W1 = 15 * MiB, WS_W2 = 23 * MiB;
constexpr size_t WS_MISC = 31 * MiB;
constexpr size_t WS_MOD = WS_MISC;
constexpr size_t WS_BIAS = WS_MOD + 65536;
constexpr size_t WS_FCA = WS_BIAS + 32768;
constexpr size_t WS_FCB = WS_FCA + 131072;
constexpr size_t WS_DEC = WS_FCB + 65536;
constexpr size_t WS_CTXS = 33 * MiB;
constexpr size_t WS_R1 = 34 * MiB;
constexpr size_t WS_GATEF = WS_R1 + 34078720;
constexpr size_t WS_GATEH = WS_GATEF + 32 * MiB;
constexpr size_t WS_Z = WS_GATEH + 32 * MiB;
constexpr size_t WS_Q = WS_Z + 32 * MiB;
constexpr size_t WS_V = WS_Q + 17039360;
constexpr size_t WS_GF = WS_V + 17039360;
constexpr size_t WS_GB = WS_GF + 17039360;
constexpr size_t WS_OG = WS_GB + 17039360;
constexpr size_t WS_END = WS_OG + 16 * MiB;
constexpr size_t WS_T1 = WS_Z;
constexpr size_t WS_YF = WS_R1;
constexpr size_t WS_ST = WS_R1;
constexpr size_t WS_YMIX = WS_R1;
constexpr size_t WS_Z1 = WS_GATEH;
constexpr size_t WS_A2 = WS_Q;
constexpr size_t WS_HID = WS_R1;
static_assert(WS_DEC + 8 * 260 * 128 * 4 <= WS_CTXS, "misc overflow");
static_assert(WS_HID + 128 * MiB <= WS_A2, "hid overlaps a2");
static_assert(WS_END <= 256 * MiB, "ws overflow");

constexpr int LDS_BYTES = 131072;

__device__ __forceinline__ u16 f2bf(float f) { unsigned u = __float_as_uint(f); u += 0x7FFFu + ((u >> 16) & 1u); return (u16)(u >> 16); }
__device__ __forceinline__ float bf2f(u16 b) { return __uint_as_float(((unsigned)b) << 16); }
__device__ __forceinline__ float bflo(unsigned w) { return __uint_as_float(w << 16); }
__device__ __forceinline__ float bfhi(unsigned w) { return __uint_as_float(w & 0xffff0000u); }
typedef __bf16 bf16x2_t __attribute__((ext_vector_type(2)));
typedef float f32x2_t __attribute__((ext_vector_type(2)));
__device__ __forceinline__ unsigned pk_bf16(float lo, float hi) { const f32x2_t f = {lo, hi}; const bf16x2_t v = __builtin_convertvector(f, bf16x2_t); return __builtin_bit_cast(unsigned, v); }
__device__ __forceinline__ unsigned pk_f16(float lo, float hi) { typedef _Float16 h2 __attribute__((ext_vector_type(2))); h2 v; v.x = (_Float16)lo; v.y = (_Float16)hi; return __builtin_bit_cast(unsigned, v); }
__device__ __forceinline__ float sigmoidf_(float x) { return __builtin_amdgcn_rcpf(1.0f + __expf(-x)); }
__device__ __forceinline__ float siluf_(float x) { return x * sigmoidf_(x); }
__device__ __forceinline__ float wave_sum(float v) { for (int o = 32; o >= 1; o >>= 1) v += __shfl_xor(v, o); return v; }
__device__ __forceinline__ float sin_rev(float r) { return __builtin_amdgcn_sinf(r); }
__device__ __forceinline__ float cos_rev(float r) { return __builtin_amdgcn_cosf(r); }

namespace pg8 {
#define PG8_LAS __attribute__((address_space(3)))
typedef unsigned short bf16_t;
typedef short bf16x8 __attribute__((ext_vector_type(8)));
typedef float f32x4 __attribute__((ext_vector_type(4)));
typedef unsigned u32x4 __attribute__((ext_vector_type(4)));
constexpr int BM = 256, BK = 64, HALF = 128, HTB = HALF * BK * 2  , STAGE_BYTES = 8 * HTB, NXCD = 8, WGM = 8;

__host__ __device__ __forceinline__ int lds_byte(int r, int c) { const int st = (r >> 4) * 2 + (c >> 5), rr = r & 15, cc = c & 31, ob = rr * 64 + cc * 2; return st * 1024 + (ob ^ (((ob >> 9) & 1) << 5)); }
__host__ __device__ __forceinline__ void stage_rc(int b, int& R, int& C) { const int st = b / 1024, sb = b % 1024, swz = sb ^ (((sb >> 9) & 1) << 5); R = (st >> 1) * 16 + swz / 64; C = (st & 1) * 32 + (swz % 64) / 2; }
__host__ __device__ __forceinline__ int perm32(int rho) { const int n = rho >> 4, i = rho & 15; return 8 * (i >> 2) + 4 * n + (i & 3); }

struct Unit { int pm, pn; };
struct Gemm { const bf16_t* A; const bf16_t* Bt; int M, N, K; };

struct StaticOrder {
    int nM, nN, nwg, G, c;
    __host__ __device__ void init(int M, int N, int G_, int c_) { nM = M / BM; nN = N / BM; nwg = nM * nN; G = G_; c = c_; }
    __host__ __device__ bool next(int i, Unit& u) const {
        const long L = (long)i * G + c; if (L >= nwg) return false;
        int wgid = (int)L; { const int q = nwg / NXCD, r = nwg % NXCD, xcd = wgid % NXCD, off = wgid / NXCD; wgid = (xcd < r ? xcd * (q + 1) : r * (q + 1) + (xcd - r) * q) + off; }
        const int nig = WGM * nN, gid = wgid / nig, fm = gid * WGM, gsz = (nM - fm) < WGM ? (nM - fm) : WGM;
        u.pm = fm + ((wgid % nig) % gsz); u.pn = (wgid % nig) / gsz; return true;
    }
    __device__ __forceinline__ void a_ready(const Unit&) const {}
    __device__ __forceinline__ void done(const Unit&) const {}
};
__device__ __forceinline__ unsigned cvt_pk_bf16(float lo, float hi) { unsigned r; asm volatile("v_cvt_pk_bf16_f32 %0, %1, %2" : "=v"(r) : "v"(lo), "v"(hi)); return r; }
typedef float f32x2 __attribute__((ext_vector_type(2)));
template <class Epi, class Sched, bool STAMP = false>
__device__ __forceinline__ void gemm_phase(PG8_LAS unsigned char* lds, const Gemm g, const Sched& S, const Epi& E, unsigned long long* stamps) {
    const int tid = threadIdx.x, wid = __builtin_amdgcn_readfirstlane(tid >> 6), lane = tid & 63, wr = wid >> 2, wc = wid & 3, fr = lane & 15, fq = lane >> 4;
    const int K = g.K, nt = K / BK;
    int ts_lo = 0, ts_hi = 0, nts = 0; const unsigned long long rt_entry = STAMP ? (unsigned long long)wall_clock64() : 0ull;
#define PG8_STAMP() do { if (STAMP && wid == 0 && nts < 64) { const unsigned long long _c = (unsigned long long)clock64(); \
        ts_lo = (lane == nts) ? (int)(unsigned)_c : ts_lo; ts_hi = (lane == nts) ? (int)(unsigned)(_c >> 32) : ts_hi; ++nts; } } while (0)
    PG8_STAMP();
    unsigned voffA[2], voffB[2];
#pragma unroll
    for (int i = 0; i < 2; ++i) { int R, C; stage_rc(tid * 16 + i * 8192, R, C); const int Rb = Epi::PERM ? ((R & ~31) + perm32(R & 31)) : R;
        voffA[i] = (unsigned)(R * K + C) * 2u; voffB[i] = (unsigned)(Rb * K + C) * 2u; }
    const size_t kstep = (size_t)(BK * 2);
    const size_t hstep = (size_t)HALF * K * 2;
    const size_t tstep = 2 * hstep;
    const unsigned ldsw = (unsigned)wid * 1024u;
    const int aoff = lds_byte(wr * 64 + fr, fq * 8), boff = lds_byte(wc * 32 + fr, fq * 8);
#define PG8_SA(b, h) (((b) * 2 + (h)) * HTB)
#define PG8_SB(b, h) ((4 + (b) * 2 + (h)) * HTB)
#define PG8_STAGE(bufoff, gbase, voff) do { _Pragma("unroll") for (int _i = 0; _i < 2; ++_i) \
        __builtin_amdgcn_global_load_lds((const unsigned*)((const char*)(gbase) + (voff)[_i]), (PG8_LAS unsigned*)(lds + (bufoff) + ldsw + _i * 8192), 16, 0, 0); } while (0)
#define PG8_LDA(dst, b, h) do { _Pragma("unroll") for (int m = 0; m < 4; ++m) _Pragma("unroll") for (int k = 0; k < 2; ++k) dst[m][k] = *(const PG8_LAS bf16x8*)(lds + PG8_SA(b, h) + aoff + m * 2048 + k * 1024); } while (0)
#define PG8_LDB(dst, b, h) do { _Pragma("unroll") for (int n = 0; n < 2; ++n) _Pragma("unroll") for (int k = 0; k < 2; ++k) dst[n][k] = *(const PG8_LAS bf16x8*)(lds + PG8_SB(b, h) + boff + n * 2048 + k * 1024); } while (0)
#define PG8_MMA(ai, bj, At, Bt) do { __builtin_amdgcn_s_setprio(1); _Pragma("unroll") for (int m = 0; m < 4; ++m) _Pragma("unroll") for (int n = 0; n < 2; ++n) _Pragma("unroll") for (int k = 0; k < 2; ++k) \
        acc[ai][bj][m][n] = __builtin_amdgcn_mfma_f32_16x16x32_bf16(Bt[n][k], At[m][k], acc[ai][bj][m][n], 0, 0, 0); __builtin_amdgcn_s_setprio(0); } while (0)
#define PG8_WAIT_V(n) asm volatile("s_waitcnt vmcnt(" #n ")" ::: "memory")
#define PG8_WAIT_L(n) asm volatile("s_waitcnt lgkmcnt(" #n ")" ::: "memory")
#define PG8_BAR __builtin_amdgcn_s_barrier()
#define PG8_SCHED __builtin_amdgcn_sched_barrier(0)
    Unit cur, nxt; int ui = 0;
    if (!S.next(0, cur)) return;
    f32x4 acc[2][2][4][2];
#pragma unroll
    for (int a = 0; a < 2; ++a)
#pragma unroll
        for (int b = 0; b < 2; ++b)
#pragma unroll
            for (int m = 0; m < 4; ++m)
#pragma unroll
                for (int n = 0; n < 2; ++n) acc[a][b][m][n] = (f32x4){0.f, 0.f, 0.f, 0.f};
    bf16x8 At[4][2], B0[2][2], B1[2][2];
    const char* cA = (const char*)g.A + (size_t)cur.pm * tstep; const char* cB = (const char*)g.Bt + (size_t)cur.pn * tstep;
    S.a_ready(cur);
    PG8_STAGE(PG8_SB(0, 0), cB, voffB); PG8_STAGE(PG8_SA(0, 0), cA, voffA); PG8_STAGE(PG8_SB(0, 1), cB + hstep, voffB); PG8_STAGE(PG8_SA(0, 1), cA + hstep, voffA);
    if (wr == 1) PG8_BAR;
    PG8_WAIT_V(4); PG8_BAR;
    PG8_STAGE(PG8_SB(1, 0), cB + kstep, voffB); PG8_STAGE(PG8_SA(1, 0), cA + kstep, voffA); PG8_STAGE(PG8_SB(1, 1), cB + hstep + kstep, voffB);
    PG8_WAIT_V(6); PG8_BAR;
    PG8_STAMP();
    for (;;) {
        const bool has_next = S.next(ui + 1, nxt);
        const char* nA = has_next ? (const char*)g.A + (size_t)nxt.pm * tstep : cA; const char* nB = has_next ? (const char*)g.Bt + (size_t)nxt.pn * tstep : cB;
        for (int t = 0; t < nt; t += 2) {
            const bool last = (t == nt - 2);
            const char* a1 = cA + (size_t)(t + 1) * kstep;
            const char* a2 = last ? nA : cA + (size_t)(t + 2) * kstep; const char* b2 = last ? nB : cB + (size_t)(t + 2) * kstep;
            const char* a3 = a2 + kstep; const char* b3 = b2 + kstep;
            if (last && has_next) S.a_ready(nxt);
            PG8_LDB(B0, 0, 0); PG8_SCHED; PG8_LDA(At, 0, 0); PG8_STAGE(PG8_SA(1, 1), a1 + hstep, voffA);
            PG8_WAIT_L(8); PG8_BAR; PG8_WAIT_L(0); PG8_MMA(0, 0, At, B0); PG8_BAR; PG8_SCHED;
            PG8_LDB(B1, 0, 1); PG8_STAGE(PG8_SB(0, 0), b2, voffB);
            PG8_BAR; PG8_WAIT_L(0); PG8_MMA(0, 1, At, B1); PG8_BAR;
            PG8_LDA(At, 0, 1); PG8_STAGE(PG8_SA(0, 0), a2, voffA);
            PG8_BAR; PG8_WAIT_L(0); PG8_MMA(1, 0, At, B0); PG8_BAR; PG8_SCHED;
            PG8_STAGE(PG8_SB(0, 1), b2 + hstep, voffB);
            PG8_WAIT_V(6); PG8_BAR; PG8_MMA(1, 1, At, B1); PG8_BAR;
            PG8_LDB(B0, 1, 0); PG8_SCHED; PG8_LDA(At, 1, 0); PG8_STAGE(PG8_SA(0, 1), a2 + hstep, voffA);
            PG8_WAIT_L(8); PG8_BAR; PG8_WAIT_L(0); PG8_MMA(0, 0, At, B0); PG8_BAR; PG8_SCHED;
            PG8_LDB(B1, 1, 1); PG8_STAGE(PG8_SB(1, 0), b3, voffB);
            PG8_BAR; PG8_WAIT_L(0); PG8_MMA(0, 1, At, B1); PG8_BAR;
            PG8_LDA(At, 1, 1); PG8_STAGE(PG8_SA(1, 0), a3, voffA);
            PG8_BAR; PG8_WAIT_L(0); PG8_MMA(1, 0, At, B0); PG8_BAR; PG8_SCHED;
            PG8_STAGE(PG8_SB(1, 1), b3 + hstep, voffB);
            PG8_WAIT_V(6); PG8_BAR; PG8_MMA(1, 1, At, B1); PG8_BAR;
        }
        PG8_STAMP();
        if constexpr (!Epi::AFTER_DRAIN) { E(acc, cur, wr, wc, fr, fq); S.done(cur); }
        PG8_STAMP();
        if (!has_next) break;
#pragma unroll
        for (int a = 0; a < 2; ++a)
#pragma unroll
            for (int b = 0; b < 2; ++b)
#pragma unroll
                for (int m = 0; m < 4; ++m)
#pragma unroll
                    for (int n = 0; n < 2; ++n) acc[a][b][m][n] = (f32x4){0.f, 0.f, 0.f, 0.f};
        cur = nxt; cA = nA; cB = nB; ++ui;
    }
    PG8_WAIT_V(0);
    if (wr == 0) PG8_BAR;
    PG8_BAR;
    if constexpr (Epi::AFTER_DRAIN) { E.fused(acc, cur, wr, wc, fr, fq, lds, wid, lane); S.done(cur); }
    PG8_STAMP();
    if (STAMP && wid == 0) { stamps[lane] = lane < nts ? (((unsigned long long)(unsigned)ts_hi << 32) | (unsigned)ts_lo) : 0ull;
        if (lane == 62) stamps[62] = rt_entry; if (lane == 63) stamps[63] = (unsigned long long)wall_clock64(); }
#undef PG8_STAMP
#undef PG8_SA
#undef PG8_SB
#undef PG8_STAGE
#undef PG8_LDA
#undef PG8_LDB
#undef PG8_MMA
#undef PG8_WAIT_V
#undef PG8_WAIT_L
#undef PG8_BAR
#undef PG8_SCHED
}
}

namespace pg8 {
__device__ __forceinline__ float act_apply(int act, float v, float lb) {
    if (act == 1) return siluf_(v);
    if (act == 2) return sigmoidf_(v);
    if (act == 3) { const float f = lb + (1.0f - lb) * sigmoidf_(v); return __logf(f); }
    return v;
}
struct EpiInProj {
    static constexpr bool PERM = true, AFTER_DRAIN = false;
    unsigned char* ws; const float* bias; const float* lbl;
    __device__ __forceinline__ void operator()(const f32x4 (&acc)[2][2][4][2], const Unit& u, int wr, int wc, int fr, int fq) const {
        const int pn = u.pn; size_t boff; int ldc, cofs, act, rows, dir = 0;
        if (pn < 4)       { boff = WS_Z;  ldc = 1024; cofs = pn * 256;        act = 0; rows = T_; }
        else if (pn < 6)  { boff = WS_Q;  ldc = 512;  cofs = (pn - 4) * 256;  act = 1; rows = T_; }
        else if (pn < 8)  { boff = WS_V;  ldc = 512;  cofs = (pn - 6) * 256;  act = 0; rows = MROWS; }
        else if (pn < 10) { boff = WS_GF; ldc = 512;  cofs = (pn - 8) * 256;  act = 3; rows = MROWS; dir = 0; }
        else if (pn < 12) { boff = WS_GB; ldc = 512;  cofs = (pn - 10) * 256; act = 3; rows = MROWS; dir = 1; }
        else if (pn < 14) { boff = WS_OG; ldc = 512;  cofs = (pn - 12) * 256; act = 1; rows = T_; }
        else if (pn < 18) { boff = WS_GATEF; ldc = 1024; cofs = (pn - 14) * 256; act = 2; rows = T_; }
        else              { boff = WS_GATEH; ldc = 1024; cofs = (pn - 18) * 256; act = 2; rows = T_; }
        if (u.pm * BM >= rows) return;
        u16* base = (u16*)(ws + boff);
        const int row0 = u.pm * BM + wr * 64 + fr, ct = wc * 32 + 8 * fq;
        f32x4 bv[2][2], lb[2][2];
#pragma unroll
        for (int bj = 0; bj < 2; ++bj)
#pragma unroll
            for (int n = 0; n < 2; ++n) {
                bv[bj][n] = *(const f32x4*)(bias + pn * BM + ct + bj * HALF + 4 * n);
                lb[bj][n] = (f32x4){0.f, 0.f, 0.f, 0.f};
                if (act == 3) { const int ch = cofs + ct + bj * HALF + 4 * n; const f32x4 l0 = *(const f32x4*)(lbl + dir * 1024 + ch), l1 = *(const f32x4*)(lbl + dir * 1024 + 512 + ch);
#pragma unroll
                    for (int j = 0; j < 4; ++j) lb[bj][n][j] = sigmoidf_(l0[j] - l1[j]); }
            }
#pragma unroll
        for (int ai = 0; ai < 2; ++ai)
#pragma unroll
            for (int m = 0; m < 4; ++m) { u16* rowp = base + (size_t)(row0 + ai * HALF + m * 16) * ldc + cofs + ct;
#pragma unroll
                for (int bj = 0; bj < 2; ++bj) { f32x4 v0 = acc[ai][bj][m][0] + bv[bj][0], v1 = acc[ai][bj][m][1] + bv[bj][1];
#pragma unroll
                    for (int j = 0; j < 4; ++j) { v0[j] = act_apply(act, v0[j], lb[bj][0][j]); v1[j] = act_apply(act, v1[j], lb[bj][1][j]); }
                    u32x4 w;
                    if (act == 3) { w.x = pk_f16(v0[0], v0[1]); w.y = pk_f16(v0[2], v0[3]); w.z = pk_f16(v1[0], v1[1]); w.w = pk_f16(v1[2], v1[3]); }
                    else { w.x = pk_bf16(v0[0], v0[1]); w.y = pk_bf16(v0[2], v0[3]); w.z = pk_bf16(v1[0], v1[1]); w.w = pk_bf16(v1[2], v1[3]); }
                    *(u32x4*)(rowp + bj * HALF) = w; } }
    }
};
template <int MODE> struct EpiPk {
    static constexpr bool PERM = true, AFTER_DRAIN = false;
    u16* O; int ldc; const u16* gate; const u16* prev; const float* bias;
    __device__ __forceinline__ void operator()(const f32x4 (&acc)[2][2][4][2], const Unit& u, int wr, int wc, int fr, int fq) const {
        const int row0 = u.pm * BM + wr * 64 + fr, col0 = u.pn * BM + wc * 32 + 8 * fq;
        f32x4 bv[2][2];
#pragma unroll
        for (int bj = 0; bj < 2; ++bj)
#pragma unroll
            for (int n = 0; n < 2; ++n) bv[bj][n] = (MODE == 2) ? *(const f32x4*)(bias + col0 + bj * HALF + 4 * n) : (f32x4){0.f, 0.f, 0.f, 0.f};
#pragma unroll
        for (int ai = 0; ai < 2; ++ai)
#pragma unroll
            for (int m = 0; m < 4; ++m) { const size_t off = (size_t)(row0 + ai * HALF + m * 16) * ldc + col0;
#pragma unroll
                for (int bj = 0; bj < 2; ++bj) { f32x4 v0 = acc[ai][bj][m][0] + bv[bj][0], v1 = acc[ai][bj][m][1] + bv[bj][1];
                    if (MODE == 2) {
#pragma unroll
                        for (int j = 0; j < 4; ++j) { const float a = fmaxf(v0[j], 0.f), b = fmaxf(v1[j], 0.f); v0[j] = a * a; v1[j] = b * b; }
                    } else {
                        const u32x4 g = *(const u32x4*)(gate + off + bj * HALF);
                        v0[0] *= bflo(g.x); v0[1] *= bfhi(g.x); v0[2] *= bflo(g.y); v0[3] *= bfhi(g.y); v1[0] *= bflo(g.z); v1[1] *= bfhi(g.z); v1[2] *= bflo(g.w); v1[3] *= bfhi(g.w);
                        if (MODE == 1) { const u32x4 p = *(const u32x4*)(prev + off + bj * HALF);
                            v0[0] += bflo(p.x); v0[1] += bfhi(p.x); v0[2] += bflo(p.y); v0[3] += bfhi(p.y); v1[0] += bflo(p.z); v1[1] += bfhi(p.z); v1[2] += bflo(p.w); v1[3] += bfhi(p.w); }
                    }
                    u32x4 w; w.x = pk_bf16(v0[0], v0[1]); w.y = pk_bf16(v0[2], v0[3]); w.z = pk_bf16(v1[0], v1[1]); w.w = pk_bf16(v1[2], v1[3]);
                    *(u32x4*)(O + off + bj * HALF) = w; } }
    }
};
struct EpiRes {
    static constexpr bool PERM = false, AFTER_DRAIN = false;
    const float* res; float* out; const float* bias; const float* gatev;
    __device__ __forceinline__ void operator()(const f32x4 (&acc)[2][2][4][2], const Unit& u, int wr, int wc, int fr, int fq) const {
        const int row0 = u.pm * BM + wr * 64 + fr, col0 = u.pn * BM + wc * 32 + 4 * fq;
        f32x4 bv[2][2], gv[2][2];
#pragma unroll
        for (int bj = 0; bj < 2; ++bj)
#pragma unroll
            for (int n = 0; n < 2; ++n) { bv[bj][n] = *(const f32x4*)(bias + col0 + bj * HALF + n * 16); gv[bj][n] = *(const f32x4*)(gatev + col0 + bj * HALF + n * 16); }
#pragma unroll
        for (int ai = 0; ai < 2; ++ai)
#pragma unroll
            for (int m = 0; m < 4; ++m) { const size_t off = (size_t)(row0 + ai * HALF + m * 16) * D_ + col0;
#pragma unroll
                for (int bj = 0; bj < 2; ++bj)
#pragma unroll
                    for (int n = 0; n < 2; ++n) { const f32x4 r = *(const f32x4*)(res + off + bj * HALF + n * 16);
                        *(f32x4*)(out + off + bj * HALF + n * 16) = ALPHA * r + gv[bj][n] * (acc[ai][bj][m][n] + bv[bj][n]); }
                asm volatile("" ::: "memory"); }
    }
};
}

struct In { const float *x, *c, *ctx, *c_ctx, *ln_in_g, *ln_in_b, *w_ada, *b_ada, *w_in, *b_in, *lbl, *hnorm_g, *w_fp, *w_hp, *w_o, *b_o, *w1, *b1, *w2, *b2, *lnp_g, *lnp_b; };
struct Args { In in; float* out; unsigned char* ws; int ph_lo, ph_hi; };

__device__ __forceinline__ void tr_tile(LAS unsigned char* lds, const float* src, int ld_src, int k0, int n0src, u16* dst, int ld_dst, int n0dst) {
    LAS float* tile = (LAS float*)lds;
    const int tid = threadIdx.x;
    { const int r = tid >> 4, c4 = tid & 15;
#pragma unroll
      for (int i = 0; i < 2; ++i) { const int k = r + 32 * i; const f32x4 v = *(const f32x4*)(src + (size_t)(k0 + k) * ld_src + n0src + c4 * 4);
          tile[k * 65 + c4 * 4 + 0] = v[0]; tile[k * 65 + c4 * 4 + 1] = v[1]; tile[k * 65 + c4 * 4 + 2] = v[2]; tile[k * 65 + c4 * 4 + 3] = v[3]; } }
    __syncthreads();
    { const int n = tid >> 3, k8 = tid & 7; float v[8];
#pragma unroll
      for (int j = 0; j < 8; ++j) v[j] = tile[(k8 * 8 + j) * 65 + n];
      u32x4 w; w.x = pk_bf16(v[0], v[1]); w.y = pk_bf16(v[2], v[3]); w.z = pk_bf16(v[4], v[5]); w.w = pk_bf16(v[6], v[7]);
      *(u32x4*)(dst + (size_t)(n0dst + n) * ld_dst + k0 + k8 * 8) = w; }
    __syncthreads();
}

__device__ void p0_prep(LAS unsigned char* lds, const Args& a, int G, int bid) {
    const int tid = threadIdx.x;
    unsigned char* ws = a.ws;
    constexpr int N_GEMV = 192, N_FOLD = 64, N_TAB = 6;
    constexpr int I_FOLD = N_GEMV, I_BIAS = I_FOLD + N_FOLD, I_TAB = I_BIAS + 1, I_TR = I_TAB + N_TAB;
    constexpr int TR0 = 1152, TR1 = 128, TR2 = 128, TR3 = 256, TR4 = 1024, TR5 = 1024, N_TR = TR0 + TR1 + TR2 + TR3 + TR4 + TR5;
    for (int it = bid; it < I_TR + N_TR; it += G) {
        if (it < N_GEMV) {
            LAS float* red = (LAS float*)lds;
            const int col = tid & 31, ks = tid >> 5, n = it * 32 + col; float a0 = 0.f, a1 = 0.f;
#pragma unroll 16
            for (int kk = 0; kk < 64; ++kk) { const int k = ks * 64 + kk; const float w = a.in.w_ada[(size_t)k * 6144 + n]; a0 += siluf_(a.in.c[k]) * w; a1 += siluf_(a.in.c_ctx[k]) * w; }
            red[(ks * 32 + col) * 2 + 0] = a0; red[(ks * 32 + col) * 2 + 1] = a1;
            __syncthreads();
            if (tid < 64) { const int v = tid >> 5, c2 = tid & 31; float s = 0.f;
#pragma unroll
                for (int q = 0; q < 16; ++q) s += red[(q * 32 + c2) * 2 + v];
                ((float*)(ws + WS_MOD))[v * 6144 + it * 32 + c2] = s + a.in.b_ada[it * 32 + c2]; }
            __syncthreads();
        } else if (it < I_BIAS) {
            const int f = it - I_FOLD, g = f >> 4, k0 = (f & 15) * 64;
            LAS float* WlT = (LAS float*)lds;
            LAS float* cosT = (LAS float*)(lds + 128 * 68 * 4); LAS float* sinT = cosT + 128;
            { const int k = tid >> 3, c16 = (tid & 7) * 16;
#pragma unroll
              for (int q = 0; q < 4; ++q) { const f32x4 v = *(const f32x4*)(a.in.w_in + (size_t)(k0 + k) * 5120 + g * 128 + c16 + 4 * q);
#pragma unroll
                  for (int j = 0; j < 4; ++j) WlT[(c16 + 4 * q + j) * 68 + k] = v[j]; } }
            if (tid < 128) { const float r = (float)tid * (1.0f / 128.0f); cosT[tid] = cos_rev(r) * INV_SQRT128; sinT[tid] = -sin_rev(r) * INV_SQRT128; }
            __syncthreads();
            { const int col = tid & 255, ri = col >> 7, cp = col & 127, kh = tid >> 8;
              float acc[32];
#pragma unroll
              for (int j = 0; j < 32; ++j) acc[j] = 0.f;
              LAS const float* tab = ri ? sinT : cosT;
              for (int c = 0; c < 128; ++c) { const float tv = tab[(c * cp) & 127];
#pragma unroll
                  for (int q = 0; q < 8; ++q) { const f32x4 w = *(LAS const f32x4*)(WlT + c * 68 + kh * 32 + 4 * q);
                      acc[4 * q + 0] += w[0] * tv; acc[4 * q + 1] += w[1] * tv; acc[4 * q + 2] += w[2] * tv; acc[4 * q + 3] += w[3] * tv; } }
              u16* dst = (u16*)(ws + WS_WIN) + (size_t)(g * 256 + ri * 128 + cp) * 1024 + k0 + kh * 32;
#pragma unroll
              for (int q = 0; q < 4; ++q) { u32x4 w; w.x = pk_bf16(acc[8 * q + 0], acc[8 * q + 1]); w.y = pk_bf16(acc[8 * q + 2], acc[8 * q + 3]); w.z = pk_bf16(acc[8 * q + 4], acc[8 * q + 5]); w.w = pk_bf16(acc[8 * q + 6], acc[8 * q + 7]);
                  *(u32x4*)(dst + 8 * q) = w; } }
            __syncthreads();
        } else if (it < I_TAB) {
            float* bo = (float*)(ws + WS_BIAS);
            for (int n = tid; n < NPROJ; n += 512) {
                if (n >= 1024) bo[n] = a.in.b_in[n - 512];
                else { const int g = n >> 8, ri = (n >> 7) & 1, cp = n & 127; float s = 0.f;
                    for (int c = 0; c < 128; ++c) { const float r = (float)((c * cp) & 127) * (1.0f / 128.0f); s += a.in.b_in[g * 128 + c] * (ri ? -sin_rev(r) : cos_rev(r)); }
                    bo[n] = s * INV_SQRT128; }
            }
        } else if (it < I_TR) {
            const int j = it - I_TAB; u16* fa = (u16*)(ws + WS_FCA); u16* fb = (u16*)(ws + WS_FCB);
            for (int i = 0; i < 32; ++i) { const int e = j * 16384 + tid + 512 * i;
                if (e < 65536) { const int n = e >> 8, k = e & 255, rn = n >> 7, tn = n & 127, rk = k >> 7, tk = k & 127; const float r = (float)((tn * tk) & 127) * (1.0f / 128.0f);
                    const float cs = cos_rev(r), sn = sin_rev(r); fa[e] = f2bf(((rn == rk) ? cs : (rn == 0 ? sn : -sn)) * INV_SQRT128); }
                else { const int e2 = e - 65536, n = e2 >> 8, k = e2 & 255, tk = k & 127; const float r = (float)((n * tk) & 127) * (1.0f / 128.0f);
                    fb[e2] = f2bf(((k < 128) ? cos_rev(r) : sin_rev(r)) * INV_SQRT128); } }
        } else {
            int t = it - I_TR;
            if (t < TR0) { tr_tile(lds, a.in.w_in, 5120, (t & 15) * 64, 512 + (t >> 4) * 64, (u16*)(ws + WS_WIN), 1024, 1024 + (t >> 4) * 64); continue; } t -= TR0;
            if (t < TR1) { tr_tile(lds, a.in.w_fp, 1024, (t & 7) * 64, (t >> 3) * 64, (u16*)(ws + WS_WFP), 512, (t >> 3) * 64); continue; } t -= TR1;
            if (t < TR2) { tr_tile(lds, a.in.w_hp, 1024, (t & 7) * 64, (t >> 3) * 64, (u16*)(ws + WS_WHP), 512, (t >> 3) * 64); continue; } t -= TR2;
            if (t < TR3) { tr_tile(lds, a.in.w_o, 1024, (t & 15) * 64, (t >> 4) * 64, (u16*)(ws + WS_WO), 1024, (t >> 4) * 64); continue; } t -= TR3;
            if (t < TR4) { tr_tile(lds, a.in.w1, 4096, (t & 15) * 64, (t >> 4) * 64, (u16*)(ws + WS_W1), 1024, (t >> 4) * 64); continue; } t -= TR4;
            tr_tile(lds, a.in.w2, 1024, (t & 63) * 64, (t >> 6) * 64, (u16*)(ws + WS_W2), 4096, (t >> 6) * 64);
        }
    }
}

__device__ __forceinline__ void ln_row(f32x4 (&v)[4], const float* g, const float* b, int lane) {
    float s = 0.f;
#pragma unroll
    for (int i = 0; i < 4; ++i) s += (v[i][0] + v[i][1]) + (v[i][2] + v[i][3]);
    const float mean = wave_sum(s) * (1.0f / 1024.0f); float q = 0.f;
#pragma unroll
    for (int i = 0; i < 4; ++i) { v[i] = v[i] - mean; q += (v[i][0] * v[i][0] + v[i][1] * v[i][1]) + (v[i][2] * v[i][2] + v[i][3] * v[i][3]); }
    const float rstd = __builtin_amdgcn_rsqf(wave_sum(q) * (1.0f / 1024.0f) + LN_EPS);
#pragma unroll
    for (int i = 0; i < 4; ++i) { const f32x4 gg = *(const f32x4*)(g + lane * 4 + 256 * i), bb = *(const f32x4*)(b + lane * 4 + 256 * i); v[i] = v[i] * rstd * gg + bb; }
}
__device__ __forceinline__ void store_mod_bf16(u16* dst, const f32x4 (&v)[4], const float* shift, const float* scale, int lane) {
#pragma unroll
    for (int i = 0; i < 4; ++i) { const f32x4 sh = *(const f32x4*)(shift + lane * 4 + 256 * i), sc = *(const f32x4*)(scale + lane * 4 + 256 * i);
        const f32x4 h = v[i] * (1.0f + sc) + sh; u32x2 w; w.x = pk_bf16(h[0], h[1]); w.y = pk_bf16(h[2], h[3]); *(u32x2*)(dst + lane * 4 + 256 * i) = w; }
}
__device__ void p1_ln0(const Args& a, int G, int bid) {
    const int tid = threadIdx.x, wid = tid >> 6, lane = tid & 63;
    const float* mod = (const float*)(a.ws + WS_MOD); u16* A0 = (u16*)(a.ws + WS_R1);
    for (int rg = bid; rg < MROWS / 8; rg += G) {
        const int row = rg * 8 + wid; f32x4 v[4];
        if (row < T_) {
            const int pr = row >> 6, pc = row & 63;
#pragma unroll
            for (int i = 0; i < 4; ++i) { v[i] = *(const f32x4*)(a.in.x + (size_t)row * D_ + lane * 4 + 256 * i);
#pragma unroll
                for (int j = 0; j < 4; ++j) { const int d = lane * 4 + 256 * i + j, dd = d & 511, fi = dd & 255; const float om = exp2f(-(float)fi * 0.05190512648261504f);
                    const float ang = (float)((d < 512) ? pr : pc) * om * 0.15915494309189535f; v[i][j] += (dd < 256) ? sin_rev(ang) : cos_rev(ang); } }
            ln_row(v, a.in.ln_in_g, a.in.ln_in_b, lane);
#pragma unroll
            for (int i = 0; i < 4; ++i) *(f32x4*)(a.out + (size_t)row * D_ + lane * 4 + 256 * i) = v[i];
            store_mod_bf16(A0 + (size_t)row * D_, v, mod, mod + 1024, lane);
        } else {
#pragma unroll
            for (int i = 0; i < 4; ++i) v[i] = *(const f32x4*)(a.in.ctx + (size_t)(row - T_) * D_ + lane * 4 + 256 * i);
            ln_row(v, a.in.ln_in_g, a.in.ln_in_b, lane);
            store_mod_bf16(A0 + (size_t)row * D_, v, mod + 6144, mod + 6144 + 1024, lane);
        }
    }
}
template <bool FINAL> __device__ void p_ln_post(const Args& a, int G, int bid) {
    const int tid = threadIdx.x, wid = tid >> 6, lane = tid & 63;
    const float* mod = (const float*)(a.ws + WS_MOD); const float* src = FINAL ? a.out : (const float*)(a.ws + WS_Z1);
    const float* g = a.in.lnp_g + (FINAL ? 1024 : 0); const float* b = a.in.lnp_b + (FINAL ? 1024 : 0);
    for (int rg = bid; rg < T_ / 8; rg += G) {
        const int row = rg * 8 + wid; f32x4 v[4];
#pragma unroll
        for (int i = 0; i < 4; ++i) v[i] = *(const f32x4*)(src + (size_t)row * D_ + lane * 4 + 256 * i);
        ln_row(v, g, b, lane);
#pragma unroll
        for (int i = 0; i < 4; ++i) *(f32x4*)(a.out + (size_t)row * D_ + lane * 4 + 256 * i) = v[i];
        if (!FINAL) store_mod_bf16((u16*)(a.ws + WS_A2) + (size_t)row * D_, v, mod + 3072, mod + 4096, lane);
    }
}

__device__ __forceinline__ bf16x8 tr_frag(LAS const unsigned char* p0, LAS const unsigned char* p1) {
    const s16x4 lo = __builtin_amdgcn_ds_read_tr16_b64_v4i16((LAS s16x4*)p0), hi = __builtin_amdgcn_ds_read_tr16_b64_v4i16((LAS s16x4*)p1);
    return __builtin_shufflevector(lo, hi, 0, 1, 2, 3, 4, 5, 6, 7);
}
constexpr int FP = 528;
template <int STAGE> __device__ void fft_stage(LAS unsigned char* lds, const Args& a, int G, int bid) {
    constexpr int NT = STAGE == 0 ? 2 : 1;
    const int tid = threadIdx.x, wid = tid >> 6, lane = tid & 63, r = lane & 15, kq = lane >> 4, q = (lane & 15) >> 2, p = lane & 3;
    u16* Zb = (u16*)(a.ws + WS_Z); u16* Yf = (u16*)(a.ws + WS_YF);
    const u16* F = (const u16*)(a.ws + (STAGE == 0 ? WS_FCA : WS_FCB));
    bf16x8 bf[NT][8];
#pragma unroll
    for (int nt = 0; nt < NT; ++nt)
#pragma unroll
        for (int ks = 0; ks < 8; ++ks) bf[nt][ks] = *(const bf16x8*)(F + (size_t)(nt * 128 + 16 * wid + r) * 256 + ks * 32 + kq * 8);
    LAS const unsigned char* trb = lds + (8 * kq + q) * FP + 8 * p;
    for (int item = bid; item < 512; item += G) {
        const int g = item >> 7, xx = item & 127;
#pragma unroll
        for (int it = 0; it < 8; ++it) { const int L = tid + 512 * it, i = L >> 5, cc = L & 31; const int rowi = STAGE == 0 ? (xx + 128 * i) : (128 * xx + i);
            const u32x4 v = *(const u32x4*)(Zb + (size_t)rowi * 1024 + g * 256 + cc * 8); *(LAS u32x4*)(lds + i * FP + cc * 16) = v; }
        __syncthreads();
        f32x4 acc[8][NT];
#pragma unroll
        for (int mt = 0; mt < 8; ++mt)
#pragma unroll
            for (int nt = 0; nt < NT; ++nt) acc[mt][nt] = (f32x4){0.f, 0.f, 0.f, 0.f};
#pragma unroll
        for (int ks = 0; ks < 8; ++ks) { const int ri = ks >> 2, i0 = (ks & 3) * 32;
#pragma unroll
            for (int mt = 0; mt < 8; ++mt) { LAS const unsigned char* ap = trb + i0 * FP + (ri * 128 + 16 * mt) * 2; const bf16x8 A = tr_frag(ap, ap + 4 * FP);
#pragma unroll
                for (int nt = 0; nt < NT; ++nt) acc[mt][nt] = __builtin_amdgcn_mfma_f32_16x16x32_bf16(A, bf[nt][ks], acc[mt][nt], 0, 0, 0); } }
        const int oi = 16 * wid + r;
        if (STAGE == 0) {
            const float fr = (float)((xx * oi) & 16383) * (1.0f / 16384.0f), cs = cos_rev(fr), sn = sin_rev(fr);
            u16* orow = Zb + (size_t)(128 * oi + xx) * 1024 + g * 256 + 4 * kq;
#pragma unroll
            for (int mt = 0; mt < 8; ++mt) { const f32x4 re = acc[mt][0], im = acc[mt][NT - 1]; const f32x4 wr_ = re * cs + im * sn, wi_ = im * cs - re * sn;
                u32x2 w0, w1; w0.x = pk_bf16(wr_[0], wr_[1]); w0.y = pk_bf16(wr_[2], wr_[3]); w1.x = pk_bf16(wi_[0], wi_[1]); w1.y = pk_bf16(wi_[2], wi_[3]);
                *(u32x2*)(orow + 16 * mt) = w0; *(u32x2*)(orow + 128 + 16 * mt) = w1; }
        } else {
            u16* orow = Yf + (size_t)(xx + 128 * oi) * 512 + g * 128 + 4 * kq;
#pragma unroll
            for (int mt = 0; mt < 8; ++mt) { const f32x4 v = acc[mt][0]; u32x2 w; w.x = pk_bf16(v[0], v[1]); w.y = pk_bf16(v[2], v[3]); *(u32x2*)(orow + 16 * mt) = w; }
        }
        __syncthreads();
    }
}

constexpr int PV = 272;
constexpr int PKT = 144;
__device__ __forceinline__ u16* st_slot(unsigned char* ws, int dh, int p) {
    return (p >= 4) ? (u16*)(ws + WS_ST) + (size_t)(dh * 256 + (p - 4)) * 16384 : (u16*)(ws + WS_CTXS) + (size_t)(dh * 4 + p) * 16384;
}
__device__ __forceinline__ float h2f(u16 h) { return (float)__builtin_bit_cast(_Float16, h); }
__device__ __forceinline__ float seg_scan(const float (&g)[16], float (&inc)[16], int dir) {
    float run = 0.f;
    if (dir == 0) {
#pragma unroll
        for (int i = 0; i < 16; ++i) { run += g[i]; inc[i] = run; }
    } else {
#pragma unroll
        for (int i = 15; i >= 0; --i) { run += g[i]; inc[i] = run; }
    }
    return run;
}
__device__ void h1_local(LAS unsigned char* lds, const Args& a, int G, int bid) {
    const int tid = threadIdx.x, wid = tid >> 6, lane = tid & 63, r = lane & 15, kq = lane >> 4, q = (lane & 15) >> 2, p = lane & 3;
    unsigned char* ws = a.ws;
    LAS unsigned char* Vs = lds; LAS unsigned char* KT = lds + 64 * PV; LAS float* segtot = (LAS float*)(lds + 64 * PV + 128 * PKT);
    const u16* Vg = (const u16*)(ws + WS_V);
    const int ch = tid & 127, seg = tid >> 7;
    for (int item = bid; item < 260 * 4; item += G) {
        const int pc = item >> 2, h = item & 3; const bool isctx = pc >= 256; const int row0 = isctx ? T_ + 64 * (pc - 256) : 64 * pc;
#pragma unroll
        for (int it = 0; it < 2; ++it) { const int L = tid + 512 * it, s = L >> 4, cc = L & 15; *(LAS u32x4*)(Vs + s * PV + cc * 16) = *(const u32x4*)(Vg + (size_t)(row0 + s) * 512 + h * 128 + cc * 8); }
        for (int dir = 0; dir < 2; ++dir) {
            const u16* Gg = (const u16*)(ws + (dir ? WS_GB : WS_GF));
            const int pslot = dir == 0 ? (isctx ? pc - 256 : 4 + pc) : (isctx ? 3 - (pc - 256) : 4 + 255 - pc);
            const int dh = dir * 4 + h;
            float g[16], inc[16];
#pragma unroll
            for (int i = 0; i < 16; ++i) g[i] = h2f(Gg[(size_t)(row0 + 16 * seg + i) * 512 + h * 128 + ch]);
            const float tot_seg = seg_scan(g, inc, dir);
            segtot[seg * 128 + ch] = tot_seg;
            __syncthreads();
            float off = 0.f, total = 0.f;
#pragma unroll
            for (int s2 = 0; s2 < 4; ++s2) { const float t = segtot[s2 * 128 + ch]; total += t; if (dir == 0 ? (s2 < seg) : (s2 > seg)) off += t; }
            float kt[16];
#pragma unroll
            for (int i = 0; i < 16; ++i) kt[i] = (1.0f - __expf(g[i])) * __expf(total - (inc[i] + off));
            u32x4 w0, w1;
            w0.x = pk_bf16(kt[0], kt[1]); w0.y = pk_bf16(kt[2], kt[3]); w0.z = pk_bf16(kt[4], kt[5]); w0.w = pk_bf16(kt[6], kt[7]);
            w1.x = pk_bf16(kt[8], kt[9]); w1.y = pk_bf16(kt[10], kt[11]); w1.z = pk_bf16(kt[12], kt[13]); w1.w = pk_bf16(kt[14], kt[15]);
            *(LAS u32x4*)(KT + ch * PKT + seg * 32) = w0; *(LAS u32x4*)(KT + ch * PKT + seg * 32 + 16) = w1;
            if (seg == 0) ((float*)(ws + WS_DEC))[(size_t)(dh * 260 + pslot) * 128 + ch] = __expf(total);
            __syncthreads();
            f32x4 acc[8];
#pragma unroll
            for (int nt = 0; nt < 8; ++nt) acc[nt] = (f32x4){0.f, 0.f, 0.f, 0.f};
#pragma unroll
            for (int ks = 0; ks < 2; ++ks) { const bf16x8 A = *(LAS const bf16x8*)(KT + (16 * wid + r) * PKT + (ks * 32 + kq * 8) * 2);
#pragma unroll
                for (int nt = 0; nt < 8; ++nt) { LAS const unsigned char* bp = Vs + (ks * 32 + 8 * kq + q) * PV + (16 * nt + 4 * p) * 2; const bf16x8 B = tr_frag(bp, bp + 4 * PV);
                    acc[nt] = __builtin_amdgcn_mfma_f32_16x16x32_bf16(A, B, acc[nt], 0, 0, 0); } }
            u16* st = st_slot(ws, dh, pslot);
#pragma unroll
            for (int nt = 0; nt < 8; ++nt) { u32x2 w; w.x = pk_bf16(acc[nt][0], acc[nt][1]); w.y = pk_bf16(acc[nt][2], acc[nt][3]);
                *(u32x2*)(st + (size_t)(16 * nt + r) * 128 + 16 * wid + 4 * kq) = w; }
            __syncthreads();
        }
    }
}
__device__ void h2_scan(const Args& a, int G, int bid) {
    unsigned char* ws = a.ws; const float* dec = (const float*)(ws + WS_DEC);
    for (int e = bid * 512 + threadIdx.x; e < 8 * 16384; e += G * 512) {
        const int dh = e >> 14, idx = e & 16383, kch = idx & 127;
        float S = 0.f;
#pragma unroll
        for (int pp = 0; pp < 4; ++pp) S = dec[(size_t)(dh * 260 + pp) * 128 + kch] * S + bf2f(st_slot(ws, dh, pp)[idx]);
        u16* base = (u16*)(ws + WS_ST) + (size_t)dh * 256 * 16384 + idx; const float* db = dec + (size_t)(dh * 260 + 4) * 128 + kch;
        for (int c0 = 0; c0 < 256; c0 += 32) {
            u16 kv[32]; float dv[32];
#pragma unroll
            for (int u = 0; u < 32; ++u) { kv[u] = base[(size_t)(c0 + u) * 16384]; dv[u] = db[(size_t)(c0 + u) * 128]; }
#pragma unroll
            for (int u = 0; u < 32; ++u) { base[(size_t)(c0 + u) * 16384] = f2bf(S); S = dv[u] * S + bf2f(kv[u]); }
        }
    }
}
__device__ void h3_out(LAS unsigned char* lds, const Args& a, int G, int bid) {
    const int tid = threadIdx.x, wid = tid >> 6, lane = tid & 63, r = lane & 15, kq = lane >> 4, q = (lane & 15) >> 2, p = lane & 3;
    unsigned char* ws = a.ws;
    LAS unsigned char* Vs = lds; LAS unsigned char* Qt = lds + 64 * PV; LAS unsigned char* Qh = lds + 128 * PV; LAS unsigned char* Kt = lds + 192 * PV;
    LAS float* segtot = (LAS float*)(lds + 256 * PV); LAS float* rowss = segtot + 512;
    const u16* Vg = (const u16*)(ws + WS_V); u16* Qg = (u16*)(ws + WS_Q); const u16* OGg = (const u16*)(ws + WS_OG);
    const int ch = tid & 127, seg = tid >> 7, mt = wid >> 1, nh = wid & 1;
    for (int item = bid; item < 256 * 4; item += G) {
        const int c = item >> 2, h = item & 3, row0 = 64 * c;
#pragma unroll
        for (int it = 0; it < 2; ++it) { const int L = tid + 512 * it, s = L >> 4, cc = L & 15; *(LAS u32x4*)(Vs + s * PV + cc * 16) = *(const u32x4*)(Vg + (size_t)(row0 + s) * 512 + h * 128 + cc * 8); }
        f32x4 o[4];
#pragma unroll
        for (int nt = 0; nt < 4; ++nt) o[nt] = (f32x4){0.f, 0.f, 0.f, 0.f};
        for (int dir = 0; dir < 2; ++dir) {
            const u16* Gg = (const u16*)(ws + (dir ? WS_GB : WS_GF));
            const int dh = dir * 4 + h, pslot = dir == 0 ? 4 + c : 4 + 255 - c;
            float g[16], inc[16], qv[16];
#pragma unroll
            for (int i = 0; i < 16; ++i) { const size_t off = (size_t)(row0 + 16 * seg + i) * 512 + h * 128 + ch; g[i] = h2f(Gg[off]); qv[i] = bf2f(Qg[off]); }
            const float tot_seg = seg_scan(g, inc, dir);
            segtot[seg * 128 + ch] = tot_seg;
            __syncthreads();
            float off = 0.f;
#pragma unroll
            for (int s2 = 0; s2 < 4; ++s2) { const float t = segtot[s2 * 128 + ch]; if (dir == 0 ? (s2 < seg) : (s2 > seg)) off += t; }
            const float bmid = dir == 0 ? (segtot[ch] + segtot[128 + ch]) : (segtot[256 + ch] + segtot[384 + ch]);
#pragma unroll
            for (int i = 0; i < 16; ++i) { const float b = inc[i] + off; const int s = 16 * seg + i;
                *(LAS u16*)(Qt + s * PV + ch * 2) = f2bf(qv[i] * __expf(b - bmid));
                *(LAS u16*)(Qh + s * PV + ch * 2) = f2bf(qv[i] * __expf(b));
                *(LAS u16*)(Kt + s * PV + ch * 2) = f2bf((1.0f - __expf(g[i])) * __expf(bmid - b)); }
            __syncthreads();
            u32x2 pa[4];
#pragma unroll
            for (int st = 0; st < 4; ++st) {
                pa[st] = (u32x2){0u, 0u};
                const bool need = dir == 0 ? (st <= mt) : (st >= mt);
                if (need) {
                    f32x4 pacc = (f32x4){0.f, 0.f, 0.f, 0.f};
#pragma unroll
                    for (int ks = 0; ks < 4; ++ks) { const bf16x8 A = *(LAS const bf16x8*)(Kt + (16 * st + r) * PV + (ks * 32 + kq * 8) * 2), B = *(LAS const bf16x8*)(Qt + (16 * mt + r) * PV + (ks * 32 + kq * 8) * 2);
                        pacc = __builtin_amdgcn_mfma_f32_16x16x32_bf16(A, B, pacc, 0, 0, 0); }
                    const int tt = 16 * mt + r;
#pragma unroll
                    for (int j = 0; j < 4; ++j) { const int ss = 16 * st + 4 * kq + j; const bool keep = dir == 0 ? (ss <= tt) : (ss >= tt); if (!keep) pacc[j] = 0.f; }
                    pa[st].x = pk_bf16(pacc[0], pacc[1]); pa[st].y = pk_bf16(pacc[2], pacc[3]);
                }
            }
#pragma unroll
            for (int ks2 = 0; ks2 < 2; ++ks2) {
                const u32x4 aw = (u32x4){pa[2 * ks2].x, pa[2 * ks2].y, pa[2 * ks2 + 1].x, pa[2 * ks2 + 1].y};
                const bf16x8 A = __builtin_bit_cast(bf16x8, aw);
#pragma unroll
                for (int nt = 0; nt < 4; ++nt) { LAS const unsigned char* bp = Vs + (32 * ks2 + 4 * kq + q) * PV + (16 * (4 * nh + nt) + 4 * p) * 2; const bf16x8 B = tr_frag(bp, bp + 16 * PV);
                    o[nt] = __builtin_amdgcn_mfma_f32_16x16x32_bf16(A, B, o[nt], 0, 0, 0); }
            }
            const u16* st = st_slot(ws, dh, pslot);
#pragma unroll
            for (int ks = 0; ks < 4; ++ks) { const bf16x8 A = *(LAS const bf16x8*)(Qh + (16 * mt + r) * PV + (ks * 32 + kq * 8) * 2);
#pragma unroll
                for (int nt = 0; nt < 4; ++nt) { const bf16x8 B = *(const bf16x8*)(st + (size_t)(16 * (4 * nh + nt) + r) * 128 + ks * 32 + kq * 8);
                    o[nt] = __builtin_amdgcn_mfma_f32_16x16x32_bf16(A, B, o[nt], 0, 0, 0); } }
            __syncthreads();
        }
        float ssq[4];
#pragma unroll
        for (int j = 0; j < 4; ++j) { float s = 0.f;
#pragma unroll
            for (int nt = 0; nt < 4; ++nt) s += o[nt][j] * o[nt][j];
            s += __shfl_xor(s, 1); s += __shfl_xor(s, 2); s += __shfl_xor(s, 4); s += __shfl_xor(s, 8); ssq[j] = s; }
        if (r == 0) {
#pragma unroll
            for (int j = 0; j < 4; ++j) rowss[nh * 64 + 16 * mt + 4 * kq + j] = ssq[j]; }
        __syncthreads();
#pragma unroll
        for (int j = 0; j < 4; ++j) { const int t = 16 * mt + 4 * kq + j; const float rs = __builtin_amdgcn_rsqf((rowss[t] + rowss[64 + t]) * (1.0f / 128.0f) + RMS_EPS);
#pragma unroll
            for (int nt = 0; nt < 4; ++nt) { const int vch = 16 * (4 * nh + nt) + r; const size_t off = (size_t)(row0 + t) * 512 + h * 128 + vch;
                Qg[off] = f2bf(o[nt][j] * rs * a.in.hnorm_g[h * 128 + vch] * bf2f(OGg[off])); } }
        __syncthreads();
    }
}

constexpr int NPH = 15;
__global__ void __launch_bounds__(512, 2) fwd_kernel(Args a) {
    extern __shared__ __attribute__((aligned(16))) unsigned char lds_raw[];
    LAS unsigned char* lds = (LAS unsigned char*)lds_raw;
    cg::grid_group grid = cg::this_grid();
    const int G = gridDim.x, bid = blockIdx.x, lo = a.ph_lo, hi = a.ph_hi;
    unsigned char* ws = a.ws;
#define IN(k) (lo <= (k) && (k) < hi)
#define SEAM(k) do { if (IN((k) + 1)) grid.sync(); } while (0)
    if (IN(0)) { p0_prep(lds, a, G, bid); SEAM(0); }
    if (IN(1)) { p1_ln0(a, G, bid); SEAM(1); }
    if (IN(2)) {
        pg8::Gemm g{(const u16*)(ws + WS_R1), (const u16*)(ws + WS_WIN), MROWS, NPROJ, D_}; pg8::StaticOrder S; S.init(MROWS, NPROJ, G, bid);
        pg8::EpiInProj E{ws, (const float*)(ws + WS_BIAS), a.in.lbl};
        pg8::gemm_phase<pg8::EpiInProj, pg8::StaticOrder>(lds, g, S, E, nullptr); SEAM(2);
    }
    if (IN(3)) { fft_stage<0>(lds, a, G, bid); SEAM(3); }
    if (IN(4)) { fft_stage<1>(lds, a, G, bid); SEAM(4); }
    if (IN(5)) {
        pg8::Gemm g{(const u16*)(ws + WS_YF), (const u16*)(ws + WS_WFP), T_, D_, 512}; pg8::StaticOrder S; S.init(T_, D_, G, bid);
        pg8::EpiPk<0> E{(u16*)(ws + WS_T1), D_, (const u16*)(ws + WS_GATEF), nullptr, nullptr};
        pg8::gemm_phase<pg8::EpiPk<0>, pg8::StaticOrder>(lds, g, S, E, nullptr); SEAM(5);
    }
    if (IN(6)) { h1_local(lds, a, G, bid); SEAM(6); }
    if (IN(7)) { h2_scan(a, G, bid); SEAM(7); }
    if (IN(8)) { h3_out(lds, a, G, bid); SEAM(8); }
    if (IN(9)) {
        pg8::Gemm g{(const u16*)(ws + WS_Q), (const u16*)(ws + WS_WHP), T_, D_, 512}; pg8::StaticOrder S; S.init(T_, D_, G, bid);
        pg8::EpiPk<1> E{(u16*)(ws + WS_YMIX), D_, (const u16*)(ws + WS_GATEH), (const u16*)(ws + WS_T1), nullptr};
        pg8::gemm_phase<pg8::EpiPk<1>, pg8::StaticOrder>(lds, g, S, E, nullptr); SEAM(9);
    }
    if (IN(10)) {
        pg8::Gemm g{(const u16*)(ws + WS_YMIX), (const u16*)(ws + WS_WO), T_, D_, D_}; pg8::StaticOrder S; S.init(T_, D_, G, bid);
        pg8::EpiRes E{a.out, (float*)(ws + WS_Z1), a.in.b_o, (const float*)(ws + WS_MOD) + 2048};
        pg8::gemm_phase<pg8::EpiRes, pg8::StaticOrder>(lds, g, S, E, nullptr); SEAM(10);
    }
    if (IN(11)) { p_ln_post<false>(a, G, bid); SEAM(11); }
    if (IN(12)) {
        pg8::Gemm g{(const u16*)(ws + WS_A2), (const u16*)(ws + WS_W1), T_, DFF, D_}; pg8::StaticOrder S; S.init(T_, DFF, G, bid);
        pg8::EpiPk<2> E{(u16*)(ws + WS_HID), DFF, nullptr, nullptr, a.in.b1};
        pg8::gemm_phase<pg8::EpiPk<2>, pg8::StaticOrder>(lds, g, S, E, nullptr); SEAM(12);
    }
    if (IN(13)) {
        pg8::Gemm g{(const u16*)(ws + WS_HID), (const u16*)(ws + WS_W2), T_, D_, DFF}; pg8::StaticOrder S; S.init(T_, D_, G, bid);
        pg8::EpiRes E{a.out, a.out, a.in.b2, (const float*)(ws + WS_MOD) + 5120};
        pg8::gemm_phase<pg8::EpiRes, pg8::StaticOrder>(lds, g, S, E, nullptr); SEAM(13);
    }
    if (IN(14)) { p_ln_post<true>(a, G, bid); }
#undef IN
#undef SEAM
}

#ifndef N_LAUNCHES
#define N_LAUNCHES 15
#endif
extern "C" void kernel_launch(void* const* d_in, const int* in_sizes, int n_in, void* d_out, int out_size, void* d_ws, size_t ws_size, hipStream_t stream) {
    static int grid = 0;
    if (grid == 0) {
        int dev = 0, cus = 0, per_cu = 0;
        hipGetDevice(&dev); hipDeviceGetAttribute(&cus, hipDeviceAttributeMultiprocessorCount, dev);
        hipFuncSetAttribute((const void*)fwd_kernel, hipFuncAttributeMaxDynamicSharedMemorySize, LDS_BYTES);
        hipOccupancyMaxActiveBlocksPerMultiprocessor(&per_cu, (const void*)fwd_kernel, 512, LDS_BYTES);
        if (per_cu < 1) { fprintf(stderr, "kernel_launch: occupancy query says %d blocks/CU\n", per_cu); per_cu = 1; }
        grid = cus * 1;
        if (n_in != 22 || ws_size < WS_END) fprintf(stderr, "kernel_launch: unexpected n_in %d / ws_size %zu\n", n_in, ws_size);
    }
    Args a{};
    const float** pp = (const float**)&a.in;
    for (int i = 0; i < 22; ++i) pp[i] = (const float*)d_in[i];
    a.out = (float*)d_out; a.ws = (unsigned char*)d_ws;
    if (N_LAUNCHES == 1) {
        a.ph_lo = 0; a.ph_hi = NPH; void* args[] = {&a};
        hipError_t e = hipLaunchCooperativeKernel((const void*)fwd_kernel, dim3(grid), dim3(512), args, LDS_BYTES, stream);
        if (e != hipSuccess) fprintf(stderr, "cooperative launch failed: %s (grid %d)\n", hipGetErrorString(e), grid);
    } else {
        for (int ph = 0; ph < NPH; ++ph) { a.ph_lo = ph; a.ph_hi = ph + 1; void* args[] = {&a};
            (void)args; hipLaunchKernelGGL(fwd_kernel, dim3(grid), dim3(512), LDS_BYTES, stream, a);
            hipError_t e = hipPeekAtLastError();
            if (e != hipSuccess) fprintf(stderr, "launch %d failed: %s (grid %d)\n", ph, hipGetErrorString(e), grid); }
    }
}
```
